# Optimizing an MI355X kernel written in HIP

```python
import jax, jax.numpy as jnp
from jax import lax
import numpy as np

D_MODEL = 1024
BATCH = 2
SEQ = 8192
DEPTH = 2

N_MIXERS = 2
HEAD_DIM = 64
N_Q_HEADS = D_MODEL // HEAD_DIM
N_KV_HEADS = N_Q_HEADS // 4
GROUP = N_Q_HEADS // N_KV_HEADS
ROT_DIM = HEAD_DIM // 4
ROPE_THETA = 500000.0
WINDOW = 128
BLOCK = 128
IDX_HEADS = 8
IDX_DIM = 64
IDX_ROT_DIM = IDX_DIM // 4
TOPK_MAX = 256
D_FF = 4 * D_MODEL
EPS = 1e-6
N_A = (DEPTH + 1) // 2
N_B = DEPTH // 2
QD = N_Q_HEADS * HEAD_DIM
KVD = N_KV_HEADS * HEAD_DIM
A_IN = QD + 2 * KVD
B_SPLITS = [QD, QD + KVD, QD + 2 * KVD, QD + 2 * KVD + IDX_HEADS * IDX_DIM,
            QD + 2 * KVD + IDX_HEADS * IDX_DIM + IDX_DIM]
B_IN = B_SPLITS[-1] + IDX_HEADS

kernel_name = "hybrid_swa_sink_dsa_trunk"


def rmsnorm(x, g):
    xf = x.astype(jnp.float32)
    y = xf * lax.rsqrt(jnp.mean(xf * xf, axis=-1, keepdims=True) + EPS)
    return (y * g.astype(jnp.float32)).astype(x.dtype)


def partial_rope(x, pos, rot_dim):
    inv = ROPE_THETA ** (-jnp.arange(0, rot_dim, 2, dtype=jnp.float32) / rot_dim)
    ang = pos.astype(jnp.float32)[..., None] * inv
    cos = jnp.cos(ang)[:, :, None, :]
    sin = jnp.sin(ang)[:, :, None, :]
    half = rot_dim // 2
    x1 = x[..., :half].astype(jnp.float32)
    x2 = x[..., half:rot_dim].astype(jnp.float32)
    rot = jnp.concatenate([x1 * cos - x2 * sin, x2 * cos + x1 * sin], axis=-1)
    return jnp.concatenate([rot.astype(x.dtype), x[..., rot_dim:]], axis=-1)


def sliding_window_sink_attention(h, pos, w_in, w_out, sinks):
    B, S, _ = h.shape
    nb = S // BLOCK
    proj = h @ w_in
    q, k, v = jnp.split(proj, [QD, QD + KVD], axis=-1)
    q = partial_rope(q.reshape(B, S, N_Q_HEADS, HEAD_DIM), pos, ROT_DIM)
    k = partial_rope(k.reshape(B, S, N_KV_HEADS, HEAD_DIM), pos, ROT_DIM)
    qb = q.reshape(B, nb, BLOCK, N_KV_HEADS, GROUP, HEAD_DIM)
    kb = k.reshape(B, nb, BLOCK, N_KV_HEADS, HEAD_DIM)
    vb = v.reshape(B, nb, BLOCK, N_KV_HEADS, HEAD_DIM)

    def with_prev(t):
        prev = jnp.concatenate([jnp.zeros_like(t[:, :1]), t[:, :-1]], axis=1)
        return jnp.concatenate([prev, t], axis=2)

    kk, vv = with_prev(kb), with_prev(vb)
    scores = jnp.einsum('bnqhgd,bnkhd->bnhgqk', qb, kk).astype(jnp.float32) * (HEAD_DIM ** -0.5)
    r = jnp.arange(BLOCK)[:, None] + BLOCK
    c = jnp.arange(2 * BLOCK)[None, :]
    diff = r - c
    within = (diff >= 0) & (diff < WINDOW)
    blk = jnp.arange(nb)[:, None, None]
    valid = within[None] & ((blk > 0) | (c[None] >= BLOCK))
    scores = jnp.where(valid[None, :, None, None], scores, -jnp.inf)
    sink = sinks.astype(jnp.float32).reshape(1, 1, N_KV_HEADS, GROUP, 1, 1)
    m = jnp.maximum(jnp.max(scores, axis=-1, keepdims=True), sink)
    p = jnp.exp(scores - m)
    probs = p / (jnp.sum(p, axis=-1, keepdims=True) + jnp.exp(sink - m))
    out = jnp.einsum('bnhgqk,bnkhd->bnqhgd', probs.astype(vv.dtype), vv)
    return out.reshape(B, S, QD) @ w_out


def dsa_sparse_attention(h, pos, w_in, w_out):
    B, S, _ = h.shape
    nb = S // BLOCK
    n_sel = min(TOPK_MAX, S // 4)
    proj = h @ w_in
    q, k, v, qi, ki, wi = jnp.split(proj, B_SPLITS, axis=-1)
    q = partial_rope(q.reshape(B, S, N_Q_HEADS, HEAD_DIM), pos, ROT_DIM)
    k = partial_rope(k.reshape(B, S, N_KV_HEADS, HEAD_DIM), pos, ROT_DIM)
    v = v.reshape(B, S, N_KV_HEADS, HEAD_DIM)
    qi = partial_rope(qi.reshape(B, S, IDX_HEADS, IDX_DIM), pos, IDX_ROT_DIM)
    ki = partial_rope(ki.reshape(B, S, 1, IDX_DIM), pos, IDX_ROT_DIM)[:, :, 0]
    wi = wi * ((IDX_HEADS ** -0.5) * (IDX_DIM ** -0.5))

    qb = jnp.moveaxis(q.reshape(B, nb, BLOCK, N_KV_HEADS, GROUP, HEAD_DIM), 1, 0)
    qib = jnp.moveaxis(qi.reshape(B, nb, BLOCK, IDX_HEADS, IDX_DIM), 1, 0)
    wib = jnp.moveaxis(wi.reshape(B, nb, BLOCK, IDX_HEADS), 1, 0)
    key_pos = jnp.arange(S)

    def block(args):
        q_blk, qi_blk, wi_blk, i = args
        t = i * BLOCK + jnp.arange(BLOCK)
        logits = jnp.einsum('bthd,bsd->bths', qi_blk, ki).astype(jnp.float32)
        score = jnp.einsum('bths,bth->bts', jax.nn.relu(logits), wi_blk.astype(jnp.float32))
        score = jnp.where(key_pos[None, None, :] <= t[None, :, None], score, -jnp.inf)
        _, idx = lax.top_k(score, n_sel)
        sel_ok = idx <= t[None, :, None]
        k_sel = jax.vmap(lambda kb_, ib_: kb_[ib_])(k, idx)
        v_sel = jax.vmap(lambda vb_, ib_: vb_[ib_])(v, idx)
        s = jnp.einsum('bthgd,btkhd->bhgtk', q_blk, k_sel).astype(jnp.float32) * (HEAD_DIM ** -0.5)
        s = jnp.where(sel_ok[:, None, None], s, -jnp.inf)
        pr = jax.nn.softmax(s, axis=-1)
        return jnp.einsum('bhgtk,btkhd->bthgd', pr.astype(v_sel.dtype), v_sel)

    outs = lax.map(block, (qb, qib, wib, jnp.arange(nb)))
    out = jnp.moveaxis(outs, 0, 1).reshape(B, S, QD)
    return out @ w_out


def squared_relu_mlp(h, w_up, w_down):
    a = jax.nn.relu(h @ w_up)
    return (a * a) @ w_down


def setup_inputs(seed: int = 0) -> dict:
    key = jax.random.key(seed)
    ks = jax.random.split(key, 10)
    f32 = jnp.float32
    x = jax.random.normal(ks[0], (BATCH, SEQ, D_MODEL), f32)
    positions = jnp.broadcast_to(jnp.arange(SEQ, dtype=jnp.int32)[None, :], (BATCH, SEQ))
    norm_gains = 1.0 + 0.05 * jax.random.normal(ks[1], (DEPTH, 4, D_MODEL), f32)
    w_mlp_up = jax.random.normal(ks[2], (DEPTH, D_MODEL, D_FF), f32) * D_MODEL ** -0.5
    w_mlp_down = jax.random.normal(ks[3], (DEPTH, D_FF, D_MODEL), f32) * D_FF ** -0.5
    a_w_in = jax.random.normal(ks[4], (N_A, D_MODEL, A_IN), f32) * D_MODEL ** -0.5
    a_w_out = jax.random.normal(ks[5], (N_A, QD, D_MODEL), f32) * QD ** -0.5
    a_sinks = 0.5 * jax.random.normal(ks[6], (N_A, N_Q_HEADS), f32)
    b_w_in = jax.random.normal(ks[7], (N_B, D_MODEL, B_IN), f32) * D_MODEL ** -0.5
    b_w_out = jax.random.normal(ks[8], (N_B, QD, D_MODEL), f32) * QD ** -0.5
    return {"x": x, "positions": positions, "norm_gains": norm_gains,
            "w_mlp_up": w_mlp_up, "w_mlp_down": w_mlp_down,
            "a_w_in": a_w_in, "a_w_out": a_w_out, "a_sinks": a_sinks,
            "b_w_in": b_w_in, "b_w_out": b_w_out}


def reference(x, positions, norm_gains, w_mlp_up, w_mlp_down, a_w_in, a_w_out, a_sinks, b_w_in, b_w_out):
    ia = 0
    ib = 0
    for layer in range(DEPTH):
        g = norm_gains[layer]
        hn = rmsnorm(x, g[0])
        if layer % N_MIXERS == 0:
            mix = sliding_window_sink_attention(hn, positions, a_w_in[ia], a_w_out[ia], a_sinks[ia])
            ia += 1
        else:
            mix = dsa_sparse_attention(hn, positions, b_w_in[ib], b_w_out[ib])
            ib += 1
        x = x + rmsnorm(mix, g[1])
        hn = rmsnorm(x, g[2])
        x = x + rmsnorm(squared_relu_mlp(hn, w_mlp_up[layer], w_mlp_down[layer]), g[3])
    return x
```

```cpp
#include <hip/hip_runtime.h>
#include <cstdio>
#include <cstdint>
#include <cmath>

namespace nv {
constexpr int B_ = 2, S_ = 8192, D_ = 1024, M_ = B_ * S_, FF_ = 4096;
constexpr int NQH = 16, NKV = 4, HD = 64, QD = 1024, KVD = 256;
constexpr int A_IN = QD + 2 * KVD;
constexpr int IH = 8, IDIM = 64;
constexpr int B_IN = QD + 2 * KVD + IH * IDIM + IDIM + IH;
constexpr int OFF_K = QD, OFF_V = QD + KVD, OFF_QI = QD + 2 * KVD, OFF_KI = OFF_QI + IH * IDIM, OFF_WI = OFF_KI + IDIM;
constexpr int NSEL = 256;
constexpr float EPS = 1e-6f;

__device__ __forceinline__ float wave_sum(float v) {
#pragma unroll
    for (int o = 1; o < 64; o <<= 1) v += __shfl_xor(v, o);
    return v;
}

__global__ void __launch_bounds__(256) k_rmsnorm(const float* in, const float* g, const float* res, float* out, int rows) {
    const int lane = threadIdx.x & 63, w = (blockIdx.x * 256 + threadIdx.x) >> 6;
    if (w >= rows) return;
    const float4* xr = (const float4*)(in + (size_t)w * D_);
    float4 v[4]; float ss = 0.f;
#pragma unroll
    for (int j = 0; j < 4; ++j) { v[j] = xr[lane + 64 * j]; ss += v[j].x * v[j].x + v[j].y * v[j].y + v[j].z * v[j].z + v[j].w * v[j].w; }
    ss = wave_sum(ss);
    const float rs = 1.0f / sqrtf(ss * (1.0f / D_) + EPS);
#pragma unroll
    for (int j = 0; j < 4; ++j) {
        const float4 gg = ((const float4*)g)[lane + 64 * j];
        float4 o; o.x = v[j].x * rs * gg.x; o.y = v[j].y * rs * gg.y; o.z = v[j].z * rs * gg.z; o.w = v[j].w * rs * gg.w;
        if (res) { const float4 r = ((const float4*)(res + (size_t)w * D_))[lane + 64 * j]; o.x += r.x; o.y += r.y; o.z += r.z; o.w += r.w; }
        ((float4*)(out + (size_t)w * D_))[lane + 64 * j] = o;
    }
}

template <int ACT>
__global__ void __launch_bounds__(256) k_gemm(const float* __restrict__ A, const float* __restrict__ W, float* __restrict__ C, int M, int N, int K) {
    __shared__ float As[16][68];
    __shared__ float Ws[16][68];
    const int tid = threadIdx.x, tx = tid & 15, ty = tid >> 4;
    const int m0 = blockIdx.y * 64, n0 = blockIdx.x * 64;
    float acc[4][4];
#pragma unroll
    for (int i = 0; i < 4; ++i)
#pragma unroll
        for (int j = 0; j < 4; ++j) acc[i][j] = 0.f;
    for (int k0 = 0; k0 < K; k0 += 16) {
        {
            const int r = tid >> 2, c = (tid & 3) * 4;
            const float4 a = *(const float4*)(A + (size_t)(m0 + r) * K + k0 + c);
            As[c + 0][r] = a.x; As[c + 1][r] = a.y; As[c + 2][r] = a.z; As[c + 3][r] = a.w;
        }
        {
            const int r = tid >> 4, c = (tid & 15) * 4;
#pragma unroll
            for (int j = 0; j < 4; ++j) { const int n = n0 + c + j; Ws[r][c + j] = (n < N) ? W[(size_t)(k0 + r) * N + n] : 0.f; }
        }
        __syncthreads();
#pragma unroll
        for (int kk = 0; kk < 16; ++kk) {
            float a[4], b[4];
#pragma unroll
            for (int i = 0; i < 4; ++i) a[i] = As[kk][ty * 4 + i];
#pragma unroll
            for (int j = 0; j < 4; ++j) b[j] = Ws[kk][tx * 4 + j];
#pragma unroll
            for (int i = 0; i < 4; ++i)
#pragma unroll
                for (int j = 0; j < 4; ++j) acc[i][j] = fmaf(a[i], b[j], acc[i][j]);
        }
        __syncthreads();
    }
#pragma unroll
    for (int i = 0; i < 4; ++i)
#pragma unroll
        for (int j = 0; j < 4; ++j) {
            const int n = n0 + tx * 4 + j;
            if (n < N) { float v = acc[i][j]; if (ACT == 1) { v = fmaxf(v, 0.f); v = v * v; } C[(size_t)(m0 + ty * 4 + i) * N + n] = v; }
        }
}

__global__ void k_rope(float* proj, int ld, int off, int nheads, const int* pos, const float* inv8) {
    const long i = (long)blockIdx.x * blockDim.x + threadIdx.x;
    const long tot = (long)M_ * nheads * 8;
    if (i >= tot) return;
    const int f = i & 7; const long r = i >> 3; const int h = r % nheads; const long row = r / nheads;
    const float ang = (float)pos[row] * inv8[f];
    const float c = cosf(ang), s = sinf(ang);
    float* p = proj + row * ld + off + h * 64;
    const float x1 = p[f], x2 = p[f + 8];
    p[f] = x1 * c - x2 * s; p[f + 8] = x2 * c + x1 * s;
}

__global__ void __launch_bounds__(64) k_swa(const float* proj, const float* sinks, float* out) {
    const long i = (long)blockIdx.x * 64 + threadIdx.x;
    const int head = i & 15; const long row = i >> 4; const int b = row / S_, t = row % S_;
    const int kvh = head >> 2;
    const float* q = proj + row * A_IN + head * 64;
    float qr[64];
#pragma unroll
    for (int d = 0; d < 64; ++d) qr[d] = q[d];
    const int s0 = (t - 127 > 0) ? t - 127 : 0;
    const float sink = sinks[head];
    float m = sink;
    for (int s = s0; s <= t; ++s) {
        const float* k = proj + ((long)b * S_ + s) * A_IN + OFF_K + kvh * 64;
        float a = 0.f;
#pragma unroll
        for (int d = 0; d < 64; ++d) a = fmaf(qr[d], k[d], a);
        m = fmaxf(m, a * 0.125f);
    }
    float l = expf(sink - m);
    float o[64];
#pragma unroll
    for (int d = 0; d < 64; ++d) o[d] = 0.f;
    for (int s = s0; s <= t; ++s) {
        const float* k = proj + ((long)b * S_ + s) * A_IN + OFF_K + kvh * 64;
        const float* v = proj + ((long)b * S_ + s) * A_IN + OFF_V + kvh * 64;
        float a = 0.f;
#pragma unroll
        for (int d = 0; d < 64; ++d) a = fmaf(qr[d], k[d], a);
        const float p = expf(a * 0.125f - m);
        l += p;
#pragma unroll
        for (int d = 0; d < 64; ++d) o[d] = fmaf(p, v[d], o[d]);
    }
    const float il = 1.0f / l;
    float* op = out + row * QD + head * 64;
#pragma unroll
    for (int d = 0; d < 64; ++d) op[d] = o[d] * il;
}

__device__ __forceinline__ unsigned fkey(float f) { const unsigned u = __float_as_uint(f); return (u & 0x80000000u) ? ~u : (u | 0x80000000u); }

__global__ void __launch_bounds__(256) k_index(const float* proj, int* sel) {
    __shared__ unsigned keys[S_];
    __shared__ float qi[IH * IDIM];
    __shared__ float wi[IH];
    __shared__ int red[8];
    __shared__ int cnts[2];
    const long row = blockIdx.x; const int b = row / S_, t = row % S_;
    const int tid = threadIdx.x, n = t + 1;
    int* so = sel + row * NSEL;
    if (n <= NSEL) { if (tid < NSEL) so[tid] = (tid < n) ? tid : -1; return; }
    for (int i = tid; i < IH * IDIM; i += 256) qi[i] = proj[row * B_IN + OFF_QI + i];
    if (tid < IH) wi[tid] = proj[row * B_IN + OFF_WI + tid] * (0.35355339059327373f * 0.125f);
    __syncthreads();
    for (int s = tid; s < n; s += 256) {
        const float* k = proj + ((long)b * S_ + s) * B_IN + OFF_KI;
        float kr[64];
#pragma unroll
        for (int d = 0; d < 64; ++d) kr[d] = k[d];
        float sc = 0.f;
        for (int h = 0; h < IH; ++h) {
            float a = 0.f;
#pragma unroll
            for (int d = 0; d < 64; ++d) a = fmaf(qi[h * 64 + d], kr[d], a);
            sc = fmaf(fmaxf(a, 0.f), wi[h], sc);
        }
        keys[s] = fkey(sc);
    }
    __syncthreads();
    unsigned T = 0;
    for (int bit = 31; bit >= 0; --bit) {
        const unsigned cand = T | (1u << bit);
        int c = 0;
        for (int s = tid; s < n; s += 256) c += (keys[s] >= cand) ? 1 : 0;
#pragma unroll
        for (int o = 1; o < 64; o <<= 1) c += __shfl_xor(c, o);
        if ((tid & 63) == 0) red[tid >> 6] = c;
        __syncthreads();
        const int tot = red[0] + red[1] + red[2] + red[3];
        __syncthreads();
        if (tot >= NSEL) T = cand;
    }
    int cg = 0;
    for (int s = tid; s < n; s += 256) cg += (keys[s] > T) ? 1 : 0;
#pragma unroll
    for (int o = 1; o < 64; o <<= 1) cg += __shfl_xor(cg, o);
    if ((tid & 63) == 0) red[tid >> 6] = cg;
    if (tid == 0) { cnts[0] = 0; cnts[1] = 0; }
    __syncthreads();
    const int ngt = red[0] + red[1] + red[2] + red[3];
    const int need_eq = NSEL - ngt;
    for (int s = tid; s < n; s += 256) if (keys[s] > T) { const int p = atomicAdd(&cnts[0], 1); so[p] = s; }
    __syncthreads();
    if (tid == 0) { int c = 0; for (int s = 0; s < n && c < need_eq; ++s) if (keys[s] == T) { so[ngt + c] = s; ++c; } }
}

__global__ void __launch_bounds__(64) k_sparse(const float* proj, const int* sel, float* out) {
    const long i = (long)blockIdx.x * 64 + threadIdx.x;
    const int head = i & 15; const long row = i >> 4; const int b = row / S_;
    const int kvh = head >> 2;
    const float* q = proj + row * B_IN + head * 64;
    const int* so = sel + row * NSEL;
    float qr[64];
#pragma unroll
    for (int d = 0; d < 64; ++d) qr[d] = q[d];
    float m = -INFINITY;
    for (int j = 0; j < NSEL; ++j) {
        const int s = so[j]; if (s < 0) continue;
        const float* k = proj + ((long)b * S_ + s) * B_IN + OFF_K + kvh * 64;
        float a = 0.f;
#pragma unroll
        for (int d = 0; d < 64; ++d) a = fmaf(qr[d], k[d], a);
        m = fmaxf(m, a * 0.125f);
    }
    float l = 0.f; float o[64];
#pragma unroll
    for (int d = 0; d < 64; ++d) o[d] = 0.f;
    for (int j = 0; j < NSEL; ++j) {
        const int s = so[j]; if (s < 0) continue;
        const float* k = proj + ((long)b * S_ + s) * B_IN + OFF_K + kvh * 64;
        const float* v = proj + ((long)b * S_ + s) * B_IN + OFF_V + kvh * 64;
        float a = 0.f;
#pragma unroll
        for (int d = 0; d < 64; ++d) a = fmaf(qr[d], k[d], a);
        const float p = expf(a * 0.125f - m);
        l += p;
#pragma unroll
        for (int d = 0; d < 64; ++d) o[d] = fmaf(p, v[d], o[d]);
    }
    const float il = 1.0f / l;
    float* op = out + row * QD + head * 64;
#pragma unroll
    for (int d = 0; d < 64; ++d) op[d] = o[d] * il;
}

__global__ void k_inv(float* inv8) { if (threadIdx.x < 8) inv8[threadIdx.x] = (float)pow(500000.0, -(double)threadIdx.x / 8.0); }
}

extern "C" void kernel_launch(void* const* d_in, const int* in_sizes, int n_in, void* d_out, int out_size, void* d_ws, size_t ws_size, hipStream_t stream) {
    using namespace nv;
    const float* x = (const float*)d_in[0]; const int* pos = (const int*)d_in[1]; const float* gains = (const float*)d_in[2];
    const float* w_up = (const float*)d_in[3]; const float* w_dn = (const float*)d_in[4];
    const float* a_in = (const float*)d_in[5]; const float* a_out = (const float*)d_in[6]; const float* a_sinks = (const float*)d_in[7];
    const float* b_in = (const float*)d_in[8]; const float* b_out = (const float*)d_in[9];
    float* out = (float*)d_out; char* ws = (char*)d_ws;
    const size_t MiB = 1u << 20;
    float* R0 = (float*)(ws);
    float* R1 = (float*)(ws + 64 * MiB);
    int* sel = (int*)(ws + 208 * MiB);
    float* inv8 = (float*)(ws + 230 * MiB);
    k_inv<<<1, 64, 0, stream>>>(inv8);
    const float* xin = x;
    for (int layer = 0; layer < 2; ++layer) {
        const float* g = gains + (size_t)layer * 4 * D_;
        k_rmsnorm<<<M_ / 4, 256, 0, stream>>>(xin, g, nullptr, R0, M_);
        if (layer == 0) {
            k_gemm<0><<<dim3(A_IN / 64, M_ / 64), 256, 0, stream>>>(R0, a_in, R1, M_, A_IN, D_);
            k_rope<<<(M_ * 16 * 8 + 255) / 256, 256, 0, stream>>>(R1, A_IN, 0, 16, pos, inv8);
            k_rope<<<(M_ * 4 * 8 + 255) / 256, 256, 0, stream>>>(R1, A_IN, OFF_K, 4, pos, inv8);
            k_swa<<<M_ * 16 / 64, 64, 0, stream>>>(R1, a_sinks, R0);
            k_gemm<0><<<dim3(D_ / 64, M_ / 64), 256, 0, stream>>>(R0, a_out, R1, M_, D_, QD);
        } else {
            k_gemm<0><<<dim3((B_IN + 63) / 64, M_ / 64), 256, 0, stream>>>(R0, b_in, R1, M_, B_IN, D_);
            k_rope<<<(M_ * 16 * 8 + 255) / 256, 256, 0, stream>>>(R1, B_IN, 0, 16, pos, inv8);
            k_rope<<<(M_ * 4 * 8 + 255) / 256, 256, 0, stream>>>(R1, B_IN, OFF_K, 4, pos, inv8);
            k_rope<<<(M_ * 8 * 8 + 255) / 256, 256, 0, stream>>>(R1, B_IN, OFF_QI, 8, pos, inv8);
            k_rope<<<(M_ * 1 * 8 + 255) / 256, 256, 0, stream>>>(R1, B_IN, OFF_KI, 1, pos, inv8);
            k_index<<<M_, 256, 0, stream>>>(R1, sel);
            k_sparse<<<M_ * 16 / 64, 64, 0, stream>>>(R1, sel, R0);
            k_gemm<0><<<dim3(D_ / 64, M_ / 64), 256, 0, stream>>>(R0, b_out, R1, M_, D_, QD);
        }
        k_rmsnorm<<<M_ / 4, 256, 0, stream>>>(R1, g + D_, xin, out, M_);
        xin = out;
        k_rmsnorm<<<M_ / 4, 256, 0, stream>>>(out, g + 2 * D_, nullptr, R0, M_);
        float* hch = R1; float* y2 = (float*)((char*)R1 + 64 * MiB);
        for (int c = 0; c < 4; ++c) {
            const int rows = M_ / 4;
            k_gemm<1><<<dim3(FF_ / 64, rows / 64), 256, 0, stream>>>(R0 + (size_t)c * rows * D_, w_up + (size_t)layer * D_ * FF_, hch, rows, FF_, D_);
            k_gemm<0><<<dim3(D_ / 64, rows / 64), 256, 0, stream>>>(hch, w_dn + (size_t)layer * FF_ * D_, y2 + (size_t)c * rows * D_, rows, D_, FF_);
        }
        k_rmsnorm<<<M_ / 4, 256, 0, stream>>>(y2, g + 3 * D_, out, out, M_);
    }
}
```

```cpp
#include <hip/hip_runtime.h>
#include <cstdio>
#include <cstdint>
#include <cmath>

constexpr int B_ = 2, S_ = 8192, D_ = 1024, M_ = B_ * S_, FF_ = 4096;
constexpr int QD = 1024, KVD = 256, A_IN = 1536, B_IN = 2120, B_INP = 2304;
constexpr int OFF_K = 1024, OFF_V = 1280, OFF_QI = 1536, OFF_KI = 2048, OFF_WI = 2112;
constexpr int NSEL = 256;
constexpr float EPS = 1e-6f;
constexpr float WI_SCALE = 0.35355339059327373f * 0.125f;

typedef _Float16 f16;
typedef _Float16 f16x2 __attribute__((ext_vector_type(2)));
typedef _Float16 f16x4 __attribute__((ext_vector_type(4)));
typedef _Float16 f16x8 __attribute__((ext_vector_type(8)));
typedef float f32x2 __attribute__((ext_vector_type(2)));
typedef float f32x4 __attribute__((ext_vector_type(4)));
typedef float f32x16 __attribute__((ext_vector_type(16)));
typedef unsigned u32x2 __attribute__((ext_vector_type(2)));
typedef unsigned u32x4 __attribute__((ext_vector_type(4)));
typedef short s16x4 __attribute__((ext_vector_type(4)));

#define LAS __attribute__((address_space(3)))
#define GAS __attribute__((address_space(1)))

constexpr size_t MiB = 1u << 20;
constexpr size_t WS_CTL = 0, CTL_ZERO_BYTES = 64 * 1024;
constexpr size_t WS_CS = 1 * MiB;
constexpr size_t WS_WAIN = 2 * MiB, WS_WAOUT = 5 * MiB, WS_WBIN = 7 * MiB, WS_WBOUT = 12 * MiB;
constexpr size_t WS_WUP0 = 14 * MiB, WS_WUP1 = 22 * MiB, WS_WDN0 = 30 * MiB, WS_WDN1 = 38 * MiB;
constexpr size_t WS_WI = 46 * MiB;
constexpr size_t WS_BIG = 48 * MiB;
constexpr size_t WS_Q = 48 * MiB, WS_K = 80 * MiB, WS_V = 88 * MiB, WS_QI = 96 * MiB, WS_KI = 112 * MiB, WS_O = 114 * MiB;
constexpr size_t WS_Y = 176 * MiB;
constexpr size_t WS_SEL = 240 * MiB;
constexpr size_t WS_END = 256 * MiB;
constexpr int HN_LD = 2048;

__device__ __forceinline__ float wave_sum(float v) {
#pragma unroll
    for (int o = 1; o < 64; o <<= 1) v += __shfl_xor(v, o);
    return v;
}
__device__ __forceinline__ unsigned pk2h(float lo, float hi) { f32x2 v = {lo, hi}; f16x2 h = __builtin_convertvector(v, f16x2); return __builtin_bit_cast(unsigned, h); }
__device__ __forceinline__ unsigned fkey(float f) { const unsigned u = __float_as_uint(f); return (u & 0x80000000u) ? ~u : (u | 0x80000000u); }

namespace nv {
__global__ void __launch_bounds__(256) k_rms16(const float* x, const float* g, f16* hn) {
    const int lane = threadIdx.x & 63, w = (blockIdx.x * 256 + threadIdx.x) >> 6;
    const float4* xr = (const float4*)(x + (size_t)w * D_);
    float4 v[4]; float ss = 0.f;
#pragma unroll
    for (int j = 0; j < 4; ++j) { v[j] = xr[lane + 64 * j]; ss += v[j].x * v[j].x + v[j].y * v[j].y + v[j].z * v[j].z + v[j].w * v[j].w; }
    ss = wave_sum(ss);
    const float rs = 1.0f / sqrtf(ss * (1.0f / D_) + EPS);
#pragma unroll
    for (int j = 0; j < 4; ++j) {
        const float4 gg = ((const float4*)g)[lane + 64 * j];
        u32x2 o; o.x = pk2h(v[j].x * rs * gg.x, v[j].y * rs * gg.y); o.y = pk2h(v[j].z * rs * gg.z, v[j].w * rs * gg.w);
        *(u32x2*)(hn + (size_t)w * HN_LD + 4 * (lane + 64 * j)) = o;
    }
}
__global__ void __launch_bounds__(256) k_normres(const float* y, const float* xin, float* xout, const float* g1, const float* g2, f16* hn) {
    const int lane = threadIdx.x & 63, w = (blockIdx.x * 256 + threadIdx.x) >> 6;
    const float4* yr = (const float4*)(y + (size_t)w * D_);
    float4 v[4]; float ss = 0.f;
#pragma unroll
    for (int j = 0; j < 4; ++j) { v[j] = yr[lane + 64 * j]; ss += v[j].x * v[j].x + v[j].y * v[j].y + v[j].z * v[j].z + v[j].w * v[j].w; }
    ss = wave_sum(ss);
    const float rs = 1.0f / sqrtf(ss * (1.0f / D_) + EPS);
    float s2 = 0.f;
#pragma unroll
    for (int j = 0; j < 4; ++j) {
        const float4 gg = ((const float4*)g1)[lane + 64 * j];
        const float4 r = ((const float4*)(xin + (size_t)w * D_))[lane + 64 * j];
        v[j].x = r.x + v[j].x * rs * gg.x; v[j].y = r.y + v[j].y * rs * gg.y; v[j].z = r.z + v[j].z * rs * gg.z; v[j].w = r.w + v[j].w * rs * gg.w;
        s2 += v[j].x * v[j].x + v[j].y * v[j].y + v[j].z * v[j].z + v[j].w * v[j].w;
        ((float4*)(xout + (size_t)w * D_))[lane + 64 * j] = v[j];
    }
    if (g2) {
        s2 = wave_sum(s2);
        const float rs2 = 1.0f / sqrtf(s2 * (1.0f / D_) + EPS);
#pragma unroll
        for (int j = 0; j < 4; ++j) {
            const float4 gg = ((const float4*)g2)[lane + 64 * j];
            u32x2 o; o.x = pk2h(v[j].x * rs2 * gg.x, v[j].y * rs2 * gg.y); o.y = pk2h(v[j].z * rs2 * gg.z, v[j].w * rs2 * gg.w);
            *(u32x2*)(hn + (size_t)w * HN_LD + 4 * (lane + 64 * j)) = o;
        }
    }
}
struct EpY { float* y; __device__ void operator()(int r, int n, float v) const { y[(size_t)r * D_ + n] = v; } };
struct EpH { f16* h; __device__ void operator()(int r, int n, float v) const { v = fmaxf(v, 0.f); h[(size_t)r * FF_ + n] = (f16)(v * v); } };
struct EpProj { f16 *q, *k, *v, *qi, *ki; float* wi;
    __device__ void operator()(int r, int n, float x) const {
        if (n < OFF_K) q[(size_t)r * QD + n] = (f16)x;
        else if (n < OFF_V) k[(size_t)r * KVD + n - OFF_K] = (f16)x;
        else if (n < OFF_QI) v[(size_t)r * KVD + n - OFF_V] = (f16)x;
        else if (n < OFF_KI) qi[(size_t)r * 512 + n - OFF_QI] = (f16)x;
        else if (n < OFF_WI) ki[(size_t)r * 64 + n - OFF_KI] = (f16)x;
        else wi[(size_t)r * 8 + n - OFF_WI] = x;
    } };
template <class Ep>
__global__ void __launch_bounds__(256) k_gemm(const f16* __restrict__ A, int lda, const float* __restrict__ W, int N, int K, Ep ep) {
    __shared__ float As[16][68];
    __shared__ float Ws[16][68];
    const int tid = threadIdx.x, tx = tid & 15, ty = tid >> 4;
    const int m0 = blockIdx.y * 64, n0 = blockIdx.x * 64;
    float acc[4][4];
#pragma unroll
    for (int i = 0; i < 4; ++i)
#pragma unroll
        for (int j = 0; j < 4; ++j) acc[i][j] = 0.f;
    for (int k0 = 0; k0 < K; k0 += 16) {
        { const int r = tid >> 2, c = (tid & 3) * 4; const f16x4 a = *(const f16x4*)(A + (size_t)(m0 + r) * lda + k0 + c);
          As[c + 0][r] = (float)a[0]; As[c + 1][r] = (float)a[1]; As[c + 2][r] = (float)a[2]; As[c + 3][r] = (float)a[3]; }
        { const int r = tid >> 4, c = (tid & 15) * 4;
#pragma unroll
          for (int j = 0; j < 4; ++j) { const int n = n0 + c + j; Ws[r][c + j] = (n < N) ? W[(size_t)(k0 + r) * N + n] : 0.f; } }
        __syncthreads();
#pragma unroll
        for (int kk = 0; kk < 16; ++kk) {
            float a[4], b[4];
#pragma unroll
            for (int i = 0; i < 4; ++i) a[i] = As[kk][ty * 4 + i];
#pragma unroll
            for (int j = 0; j < 4; ++j) b[j] = Ws[kk][tx * 4 + j];
#pragma unroll
            for (int i = 0; i < 4; ++i)
#pragma unroll
                for (int j = 0; j < 4; ++j) acc[i][j] = fmaf(a[i], b[j], acc[i][j]);
        }
        __syncthreads();
    }
#pragma unroll
    for (int i = 0; i < 4; ++i)
#pragma unroll
        for (int j = 0; j < 4; ++j) { const int n = n0 + tx * 4 + j; if (n < N) ep(m0 + ty * 4 + i, n, acc[i][j]); }
}
__global__ void k_rope16(f16* buf, int ld, int nheads, const int* pos, const float* inv8) {
    const long i = (long)blockIdx.x * blockDim.x + threadIdx.x;
    const long tot = (long)M_ * nheads * 8;
    if (i >= tot) return;
    const int f = i & 7; const long r = i >> 3; const int h = r % nheads; const long row = r / nheads;
    const float ang = (float)pos[row] * inv8[f];
    const float c = cosf(ang), s = sinf(ang);
    f16* p = buf + row * ld + h * 64;
    const float x1 = (float)p[f], x2 = (float)p[f + 8];
    p[f] = (f16)(x1 * c - x2 * s); p[f + 8] = (f16)(x2 * c + x1 * s);
}
__global__ void __launch_bounds__(64) k_swa(const f16* Q, const f16* Kb, const f16* Vb, const float* sinks, f16* out) {
    const long i = (long)blockIdx.x * 64 + threadIdx.x;
    const int head = i & 15; const long row = i >> 4; const int b = row / S_, t = row % S_;
    const int kvh = head >> 2;
    const f16* q = Q + row * QD + head * 64;
    float qr[64];
#pragma unroll
    for (int d = 0; d < 64; ++d) qr[d] = (float)q[d];
    const int s0 = (t - 127 > 0) ? t - 127 : 0;
    const float sink = sinks[head];
    float m = sink;
    for (int s = s0; s <= t; ++s) {
        const f16* k = Kb + ((long)b * S_ + s) * KVD + kvh * 64;
        float a = 0.f;
#pragma unroll
        for (int d = 0; d < 64; ++d) a = fmaf(qr[d], (float)k[d], a);
        m = fmaxf(m, a * 0.125f);
    }
    float l = expf(sink - m);
    float o[64];
#pragma unroll
    for (int d = 0; d < 64; ++d) o[d] = 0.f;
    for (int s = s0; s <= t; ++s) {
        const f16* k = Kb + ((long)b * S_ + s) * KVD + kvh * 64;
        const f16* v = Vb + ((long)b * S_ + s) * KVD + kvh * 64;
        float a = 0.f;
#pragma unroll
        for (int d = 0; d < 64; ++d) a = fmaf(qr[d], (float)k[d], a);
        const float p = expf(a * 0.125f - m);
        l += p;
#pragma unroll
        for (int d = 0; d < 64; ++d) o[d] = fmaf(p, (float)v[d], o[d]);
    }
    const float il = 1.0f / l;
    f16* op = out + row * QD + head * 64;
#pragma unroll
    for (int d = 0; d < 64; ++d) op[d] = (f16)(o[d] * il);
}
__global__ void __launch_bounds__(256) k_index(const f16* QI, const f16* KI, const float* WIv, unsigned short* sel) {
    __shared__ unsigned keys[S_];
    __shared__ float qi[512];
    __shared__ float wi[8];
    __shared__ int red[8];
    __shared__ int cnts[2];
    const long row = blockIdx.x; const int b = row / S_, t = row % S_;
    const int tid = threadIdx.x, n = t + 1;
    unsigned short* so = sel + row * NSEL;
    if (n <= NSEL) { if (tid < NSEL) so[tid] = (tid < n) ? tid : 0; return; }
    for (int i = tid; i < 512; i += 256) qi[i] = (float)QI[row * 512 + i];
    if (tid < 8) wi[tid] = WIv[row * 8 + tid] * WI_SCALE;
    __syncthreads();
    for (int s = tid; s < n; s += 256) {
        const f16* k = KI + ((long)b * S_ + s) * 64;
        float kr[64];
#pragma unroll
        for (int d = 0; d < 64; ++d) kr[d] = (float)k[d];
        float sc = 0.f;
        for (int h = 0; h < 8; ++h) {
            float a = 0.f;
#pragma unroll
            for (int d = 0; d < 64; ++d) a = fmaf(qi[h * 64 + d], kr[d], a);
            sc = fmaf(fmaxf(a, 0.f), wi[h], sc);
        }
        keys[s] = fkey(sc);
    }
    __syncthreads();
    unsigned T = 0;
    for (int bit = 31; bit >= 0; --bit) {
        const unsigned cand = T | (1u << bit);
        int c = 0;
        for (int s = tid; s < n; s += 256) c += (keys[s] >= cand) ? 1 : 0;
#pragma unroll
        for (int o = 1; o < 64; o <<= 1) c += __shfl_xor(c, o);
        if ((tid & 63) == 0) red[tid >> 6] = c;
        __syncthreads();
        const int tot = red[0] + red[1] + red[2] + red[3];
        __syncthreads();
        if (tot >= NSEL) T = cand;
    }
    int cg = 0;
    for (int s = tid; s < n; s += 256) cg += (keys[s] > T) ? 1 : 0;
#pragma unroll
    for (int o = 1; o < 64; o <<= 1) cg += __shfl_xor(cg, o);
    if ((tid & 63) == 0) red[tid >> 6] = cg;
    if (tid == 0) { cnts[0] = 0; cnts[1] = 0; }
    __syncthreads();
    const int ngt = red[0] + red[1] + red[2] + red[3];
    const int need_eq = NSEL - ngt;
    for (int s = tid; s < n; s += 256) if (keys[s] > T) { const int p = atomicAdd(&cnts[0], 1); so[p] = (unsigned short)s; }
    __syncthreads();
    if (tid == 0) { int c = 0; for (int s = 0; s < n && c < need_eq; ++s) if (keys[s] == T) { so[ngt + c] = (unsigned short)s; ++c; } }
}
__global__ void __launch_bounds__(64) k_sparse(const f16* Q, const f16* Kb, const f16* Vb, const unsigned short* sel, f16* out) {
    const long i = (long)blockIdx.x * 64 + threadIdx.x;
    const int head = i & 15; const long row = i >> 4; const int b = row / S_, t = row % S_;
    const int kvh = head >> 2;
    const f16* q = Q + row * QD + head * 64;
    const unsigned short* so = sel + row * NSEL;
    const int cnt = (t + 1 < NSEL) ? t + 1 : NSEL;
    float qr[64];
#pragma unroll
    for (int d = 0; d < 64; ++d) qr[d] = (float)q[d];
    float m = -INFINITY;
    for (int j = 0; j < cnt; ++j) {
        const int s = so[j];
        const f16* k = Kb + ((long)b * S_ + s) * KVD + kvh * 64;
        float a = 0.f;
#pragma unroll
        for (int d = 0; d < 64; ++d) a = fmaf(qr[d], (float)k[d], a);
        m = fmaxf(m, a * 0.125f);
    }
    float l = 0.f; float o[64];
#pragma unroll
    for (int d = 0; d < 64; ++d) o[d] = 0.f;
    for (int j = 0; j < cnt; ++j) {
        const int s = so[j];
        const f16* k = Kb + ((long)b * S_ + s) * KVD + kvh * 64;
        const f16* v = Vb + ((long)b * S_ + s) * KVD + kvh * 64;
        float a = 0.f;
#pragma unroll
        for (int d = 0; d < 64; ++d) a = fmaf(qr[d], (float)k[d], a);
        const float p = expf(a * 0.125f - m);
        l += p;
#pragma unroll
        for (int d = 0; d < 64; ++d) o[d] = fmaf(p, (float)v[d], o[d]);
    }
    const float il = 1.0f / l;
    f16* op = out + row * QD + head * 64;
#pragma unroll
    for (int d = 0; d < 64; ++d) op[d] = (f16)(o[d] * il);
}
}

namespace pg8 {
constexpr int BM = 256, BK = 64, HALF = 128, HTB = HALF * BK * 2, STAGE_BYTES = 8 * HTB, NXCD = 8, WGM = 8;
__host__ __device__ __forceinline__ int lds_byte(int r, int c) { const int st = (r >> 4) * 2 + (c >> 5), rr = r & 15, cc = c & 31, ob = rr * 64 + cc * 2; return st * 1024 + (ob ^ (((ob >> 9) & 1) << 5)); }
__host__ __device__ __forceinline__ void stage_rc(int b, int& R, int& C) { const int st = b / 1024, sb = b % 1024, swz = sb ^ (((sb >> 9) & 1) << 5); R = (st >> 1) * 16 + swz / 64; C = (st & 1) * 32 + (swz % 64) / 2; }
__host__ __device__ __forceinline__ int perm32(int rho) { const int n = rho >> 4, i = rho & 15; return 8 * (i >> 2) + 4 * n + (i & 3); }
struct Unit { int pm, pn; };
struct Gemm { const f16* A; const f16* Bt; int M, N, K, lda; };
struct StaticOrder {
    int nM, nN, nwg, G, c;
    __host__ __device__ void init(int M, int N, int G_, int c_) { nM = M / BM; nN = N / BM; nwg = nM * nN; G = G_; c = c_; }
    __host__ __device__ bool next(int i, Unit& u) const {
        const long L = (long)i * G + c; if (L >= nwg) return false;
        int wgid = (int)L; { const int q = nwg / NXCD, r = nwg % NXCD, xcd = wgid % NXCD, off = wgid / NXCD; wgid = (xcd < r ? xcd * (q + 1) : r * (q + 1) + (xcd - r) * q) + off; }
        const int nig = WGM * nN, gid = wgid / nig, fm = gid * WGM, gsz = (nM - fm) < WGM ? (nM - fm) : WGM;
        u.pm = fm + ((wgid % nig) % gsz); u.pn = (wgid % nig) / gsz; return true;
    }
};

struct EpiY {
    static constexpr bool PERM = true;
    float* y;
    __device__ __forceinline__ void operator()(const f32x4 (&acc)[2][2][4][2], const Unit& u, int wr, int wc, int fr, int fq) const {
        const int row0 = u.pm * BM + wr * 64 + fr, col0 = u.pn * BM + wc * 32 + 8 * fq;
#pragma unroll
        for (int ai = 0; ai < 2; ++ai)
#pragma unroll
            for (int m = 0; m < 4; ++m) { float* rowp = y + (size_t)(row0 + ai * HALF + m * 16) * D_ + col0;
#pragma unroll
                for (int bj = 0; bj < 2; ++bj) { *(f32x4*)(rowp + bj * HALF) = acc[ai][bj][m][0]; *(f32x4*)(rowp + bj * HALF + 4) = acc[ai][bj][m][1]; } }
    }
};
struct EpiH {
    static constexpr bool PERM = true;
    f16* h;
    __device__ __forceinline__ void operator()(const f32x4 (&acc)[2][2][4][2], const Unit& u, int wr, int wc, int fr, int fq) const {
        const int row0 = u.pm * BM + wr * 64 + fr, col0 = u.pn * BM + wc * 32 + 8 * fq;
#pragma unroll
        for (int ai = 0; ai < 2; ++ai)
#pragma unroll
            for (int m = 0; m < 4; ++m) { f16* rowp = h + (size_t)(row0 + ai * HALF + m * 16) * FF_ + col0;
#pragma unroll
                for (int bj = 0; bj < 2; ++bj) { f32x4 a = acc[ai][bj][m][0], b = acc[ai][bj][m][1];
#pragma unroll
                    for (int e = 0; e < 4; ++e) { a[e] = fmaxf(a[e], 0.f); a[e] *= a[e]; b[e] = fmaxf(b[e], 0.f); b[e] *= b[e]; }
                    u32x4 w; w.x = pk2h(a[0], a[1]); w.y = pk2h(a[2], a[3]); w.z = pk2h(b[0], b[1]); w.w = pk2h(b[2], b[3]);
                    *(u32x4*)(rowp + bj * HALF) = w; } }
    }
};
struct EpiProj {
    static constexpr bool PERM = true;
    f16 *q, *k, *v, *qi, *ki; float* wi; const float* cs;
    __device__ __forceinline__ void operator()(const f32x4 (&acc)[2][2][4][2], const Unit& u, int wr, int wc, int fr, int fq) const {
        const int pn = u.pn;
        f16* dst; int pitch, colt; bool rope = true;
        if (pn < 4) { dst = q; pitch = QD; colt = pn * 256; }
        else if (pn == 4) { dst = k; pitch = KVD; colt = 0; }
        else if (pn == 5) { dst = v; pitch = KVD; colt = 0; rope = false; }
        else if (pn < 8) { dst = qi; pitch = 512; colt = (pn - 6) * 256; }
        else { dst = ki; pitch = 64; colt = 0; }
        const int row0 = u.pm * BM + wr * 64 + fr;
        const bool dorope = rope && ((wc & 1) == 0) && (pn < 8 || wc == 0);
#pragma unroll
        for (int ai = 0; ai < 2; ++ai)
#pragma unroll
            for (int m = 0; m < 4; ++m) {
                const int row = row0 + ai * HALF + m * 16;
                f32x4 c0 = {1.f, 1.f, 1.f, 1.f}, c1 = c0, s0 = {0.f, 0.f, 0.f, 0.f}, s1 = s0;
                if (dorope && fq < 2) { const f32x4* t = (const f32x4*)(cs + (size_t)row * 16); c0 = t[0]; c1 = t[1]; s0 = t[2]; s1 = t[3]; if (fq == 0) { s0 = -s0; s1 = -s1; } }
#pragma unroll
                for (int bj = 0; bj < 2; ++bj) {
                    f32x4 a = acc[ai][bj][m][0], b = acc[ai][bj][m][1];
                    if (dorope) {
                        f32x4 pa, pb;
#pragma unroll
                        for (int e = 0; e < 4; ++e) { pa[e] = __shfl_xor(a[e], 16); pb[e] = __shfl_xor(b[e], 16); }
                        if (fq < 2) { a = a * c0 + pa * s0; b = b * c1 + pb * s1; }
                    }
                    if (pn < 8) {
                        u32x4 w; w.x = pk2h(a[0], a[1]); w.y = pk2h(a[2], a[3]); w.z = pk2h(b[0], b[1]); w.w = pk2h(b[2], b[3]);
                        *(u32x4*)(dst + (size_t)row * pitch + colt + bj * HALF + wc * 32 + 8 * fq) = w;
                    } else if (bj == 0) {
                        if (wc < 2) { u32x4 w; w.x = pk2h(a[0], a[1]); w.y = pk2h(a[2], a[3]); w.z = pk2h(b[0], b[1]); w.w = pk2h(b[2], b[3]);
                            *(u32x4*)(ki + (size_t)row * 64 + wc * 32 + 8 * fq) = w; }
                        else if (wc == 2 && fq == 0) { *(f32x4*)(wi + (size_t)row * 8) = a; *(f32x4*)(wi + (size_t)row * 8 + 4) = b; }
                    }
                }
            }
    }
};

template <class Epi>
__device__ __forceinline__ void gemm_phase(LAS unsigned char* lds, const Gemm g, const StaticOrder& S, const Epi& E) {
    const int tid = threadIdx.x, wid = __builtin_amdgcn_readfirstlane(tid >> 6), lane = tid & 63, wr = wid >> 2, wc = wid & 3, fr = lane & 15, fq = lane >> 4;
    const int K = g.K, nt = K / BK, lda = g.lda;
    unsigned voffA[2], voffB[2];
#pragma unroll
    for (int i = 0; i < 2; ++i) { int R, C; stage_rc(tid * 16 + i * 8192, R, C); const int Rb = Epi::PERM ? ((R & ~31) + perm32(R & 31)) : R;
        voffA[i] = (unsigned)(R * lda + C) * 2u; voffB[i] = (unsigned)(Rb * K + C) * 2u; }
    const size_t kstep = (size_t)(BK * 2);
    const size_t hstepA = (size_t)HALF * lda * 2, hstepB = (size_t)HALF * K * 2;
    const size_t tstepA = 2 * hstepA, tstepB = 2 * hstepB;
    const unsigned ldsw = (unsigned)wid * 1024u;
    const int aoff = lds_byte(wr * 64 + fr, fq * 8), boff = lds_byte(wc * 32 + fr, fq * 8);
#define PG8_SA(b, h) (((b) * 2 + (h)) * HTB)
#define PG8_SB(b, h) ((4 + (b) * 2 + (h)) * HTB)
#define PG8_STAGE(bufoff, gbase, voff) do { _Pragma("unroll") for (int _i = 0; _i < 2; ++_i) \
        __builtin_amdgcn_global_load_lds((const unsigned*)((const char*)(gbase) + (voff)[_i]), (LAS unsigned*)(lds + (bufoff) + ldsw + _i * 8192), 16, 0, 0); } while (0)
#define PG8_LDA(dst, b, h) do { _Pragma("unroll") for (int m = 0; m < 4; ++m) _Pragma("unroll") for (int k = 0; k < 2; ++k) dst[m][k] = *(const LAS f16x8*)(lds + PG8_SA(b, h) + aoff + m * 2048 + k * 1024); } while (0)
#define PG8_LDB(dst, b, h) do { _Pragma("unroll") for (int n = 0; n < 2; ++n) _Pragma("unroll") for (int k = 0; k < 2; ++k) dst[n][k] = *(const LAS f16x8*)(lds + PG8_SB(b, h) + boff + n * 2048 + k * 1024); } while (0)
#define PG8_MMA(ai, bj, At, Bt) do { __builtin_amdgcn_s_setprio(1); _Pragma("unroll") for (int m = 0; m < 4; ++m) _Pragma("unroll") for (int n = 0; n < 2; ++n) _Pragma("unroll") for (int k = 0; k < 2; ++k) \
        acc[ai][bj][m][n] = __builtin_amdgcn_mfma_f32_16x16x32_f16(Bt[n][k], At[m][k], acc[ai][bj][m][n], 0, 0, 0); __builtin_amdgcn_s_setprio(0); } while (0)
#define PG8_WAIT_V(n) asm volatile("s_waitcnt vmcnt(" #n ")" ::: "memory")
#define PG8_WAIT_L(n) asm volatile("s_waitcnt lgkmcnt(" #n ")" ::: "memory")
#define PG8_BAR __builtin_amdgcn_s_barrier()
#define PG8_SCHED __builtin_amdgcn_sched_barrier(0)
    Unit cur, nxt; int ui = 0;
    if (!S.next(0, cur)) return;
    f32x4 acc[2][2][4][2];
#pragma unroll
    for (int a = 0; a < 2; ++a)
#pragma unroll
        for (int b = 0; b < 2; ++b)
#pragma unroll
            for (int m = 0; m < 4; ++m)
#pragma unroll
                for (int n = 0; n < 2; ++n) acc[a][b][m][n] = (f32x4){0.f, 0.f, 0.f, 0.f};
    f16x8 At[4][2], B0[2][2], B1[2][2];
    const char* cA = (const char*)g.A + (size_t)cur.pm * tstepA; const char* cB = (const char*)g.Bt + (size_t)cur.pn * tstepB;
    PG8_STAGE(PG8_SB(0, 0), cB, voffB); PG8_STAGE(PG8_SB(0, 1), cB + hstepB, voffB); PG8_STAGE(PG8_SA(0, 0), cA, voffA); PG8_STAGE(PG8_SA(0, 1), cA + hstepA, voffA);
    if (wr == 1) PG8_BAR;
    PG8_WAIT_V(2); PG8_BAR;
    PG8_STAGE(PG8_SB(1, 0), cB + kstep, voffB); PG8_STAGE(PG8_SA(1, 0), cA + kstep, voffA); PG8_STAGE(PG8_SB(1, 1), cB + hstepB + kstep, voffB);
    PG8_WAIT_V(6); PG8_BAR;
    for (;;) {
        const bool has_next = S.next(ui + 1, nxt);
        const char* nA = has_next ? (const char*)g.A + (size_t)nxt.pm * tstepA : cA; const char* nB = has_next ? (const char*)g.Bt + (size_t)nxt.pn * tstepB : cB;
        for (int t = 0; t < nt; t += 2) {
            const bool last = (t == nt - 2);
            const char* a1 = cA + (size_t)(t + 1) * kstep;
            const char* a2 = last ? nA : cA + (size_t)(t + 2) * kstep; const char* b2 = last ? nB : cB + (size_t)(t + 2) * kstep;
            const char* a3 = a2 + kstep; const char* b3 = b2 + kstep;
            PG8_LDB(B0, 0, 0); PG8_LDB(B1, 0, 1); PG8_SCHED; PG8_LDA(At, 0, 0); PG8_STAGE(PG8_SA(1, 1), a1 + hstepA, voffA);
            PG8_WAIT_V(8); PG8_WAIT_L(0); PG8_BAR; PG8_MMA(0, 0, At, B0); PG8_MMA(0, 1, At, B1); PG8_BAR; PG8_SCHED;
            PG8_LDA(At, 0, 1); PG8_STAGE(PG8_SB(0, 0), b2, voffB); PG8_STAGE(PG8_SB(0, 1), b2 + hstepB, voffB); PG8_STAGE(PG8_SA(0, 0), a2, voffA);
            PG8_WAIT_V(8); PG8_WAIT_L(0); PG8_BAR; PG8_MMA(1, 0, At, B0); PG8_MMA(1, 1, At, B1); PG8_BAR; PG8_SCHED;
            PG8_LDB(B0, 1, 0); PG8_LDB(B1, 1, 1); PG8_SCHED; PG8_LDA(At, 1, 0); PG8_STAGE(PG8_SA(0, 1), a2 + hstepA, voffA);
            PG8_WAIT_V(8); PG8_WAIT_L(0); PG8_BAR; PG8_MMA(0, 0, At, B0); PG8_MMA(0, 1, At, B1); PG8_BAR; PG8_SCHED;
            PG8_LDA(At, 1, 1); PG8_STAGE(PG8_SB(1, 0), b3, voffB); PG8_STAGE(PG8_SB(1, 1), b3 + hstepB, voffB); PG8_STAGE(PG8_SA(1, 0), a3, voffA);
            PG8_WAIT_V(8); PG8_WAIT_L(0); PG8_BAR; PG8_MMA(1, 0, At, B0); PG8_MMA(1, 1, At, B1); PG8_BAR; PG8_SCHED;
        }
        if (wr == 0) PG8_BAR;
        E(acc, cur, wr, wc, fr, fq);
        if (!has_next) break;
#pragma unroll
        for (int a = 0; a < 2; ++a)
#pragma unroll
            for (int b = 0; b < 2; ++b)
#pragma unroll
                for (int m = 0; m < 4; ++m)
#pragma unroll
                    for (int n = 0; n < 2; ++n) acc[a][b][m][n] = (f32x4){0.f, 0.f, 0.f, 0.f};
        cur = nxt; cA = nA; cB = nB; ++ui;
        if (wr == 1) PG8_BAR;
    }
    PG8_WAIT_V(0);
    PG8_BAR;
#undef PG8_SA
#undef PG8_SB
#undef PG8_STAGE
#undef PG8_LDA
#undef PG8_LDB
#undef PG8_MMA
#undef PG8_WAIT_V
#undef PG8_WAIT_L
#undef PG8_BAR
#undef PG8_SCHED
}
}

constexpr int NWAVES = 8, NTHREADS = 512;
constexpr int RING_BYTES = 147456;
constexpr int LDSCTL_OFF = RING_BYTES, MISC_OFF = LDSCTL_OFF + 64;
constexpr int LDS_BYTES = RING_BYTES + 1024;
constexpr int CW_BAR = 1024;

typedef GAS unsigned gu32;
#define XB_TMO      128
#define XB_XCNT(j)  (256  + 64 * (j))
#define XB_XSUB(j)  (1280 + 64 * (j))
#define XB_XGEN(j)  (2304 + 64 * (j))
#define XB_TOP      3328
#define XB_TOPGEN   3392
#define XCD_BAR_WORDS 3456
#define XB_SPIN_CAP (1u << 18)
__device__ __forceinline__ unsigned xb_ld(unsigned* p)              { return __hip_atomic_load(p, __ATOMIC_RELAXED, __HIP_MEMORY_SCOPE_AGENT); }
__device__ __forceinline__ unsigned xb_add(unsigned* p, unsigned v) { return __hip_atomic_fetch_add(p, v, __ATOMIC_RELAXED, __HIP_MEMORY_SCOPE_AGENT); }
__device__ __forceinline__ unsigned xb_xcc_id() { return (unsigned)__builtin_amdgcn_s_getreg((3 << 11) | 20) & 0xFu; }
#define XB_SPIN(cond, bar) do { unsigned _sp = 0; while (cond) { __builtin_amdgcn_s_sleep(1); \
    if ((++_sp & 255u) == 0u) { if (xb_ld(&(bar)[XB_TMO])) break; if (_sp > XB_SPIN_CAP) { atomicAdd(&(bar)[XB_TMO], 1u); break; } } } } while (0)
struct XcdBarrier { unsigned* bar; unsigned x; volatile LAS unsigned* st; };
__device__ __forceinline__ XcdBarrier xcd_barrier_post(unsigned* bar, volatile LAS unsigned* st) {
    XcdBarrier b; b.bar = bar; b.x = xb_xcc_id(); b.st = st;
    if (threadIdx.x == 0) (void)xb_add(&bar[XB_XCNT(b.x)], 1u);
    return b;
}
__device__ __forceinline__ void xcd_barrier_complete(unsigned* bar, unsigned x, unsigned& nloc, unsigned& nx) {
    const unsigned G = gridDim.x * gridDim.y * gridDim.z;
    unsigned sum, cnt, mine, sp = 0u;
    for (;;) {
        sum = 0u; cnt = 0u; mine = 0u;
#pragma unroll
        for (unsigned j = 0; j < 16; ++j) { const unsigned c = xb_ld(&bar[XB_XCNT(j)]); sum += c; cnt += (c > 0u) ? 1u : 0u; mine = (j == x) ? c : mine; }
        if (sum == G) break;
        __builtin_amdgcn_s_sleep(1);
        if ((++sp & 255u) == 0u) { if (xb_ld(&bar[XB_TMO])) break; if (sp > XB_SPIN_CAP) { atomicAdd(&bar[XB_TMO], 1u); break; } }
    }
    nloc = mine > 0u ? mine : 1u; nx = cnt > 0u ? cnt : 1u;
}
__device__ __forceinline__ void xcd_barrier(const XcdBarrier& b) {
    asm volatile("s_waitcnt vmcnt(0)" ::: "memory");
    __syncthreads();
    if (threadIdx.x == 0) {
        unsigned* bar = b.bar;
        __builtin_amdgcn_s_waitcnt(0);
        unsigned nloc = b.st[0], nx = b.st[1];
        if (nloc == 0u) { xcd_barrier_complete(bar, b.x, nloc, nx); b.st[0] = nloc; b.st[1] = nx; }
        const unsigned old = xb_add(&bar[XB_XSUB(b.x)], 1u);
        const unsigned gen = old / nloc;
        if (old + 1u == (gen + 1u) * nloc) {
            __builtin_amdgcn_fence(__ATOMIC_RELEASE, "agent");
            asm volatile("s_waitcnt vmcnt(0)" ::: "memory");
            const unsigned og = xb_add(&bar[XB_TOP], 1u);
            const unsigned tg = og / nx;
            if (og + 1u == (tg + 1u) * nx) xb_add(&bar[XB_TOPGEN], 1u);
            else XB_SPIN(xb_ld(&bar[XB_TOPGEN]) == tg, bar);
            __builtin_amdgcn_fence(__ATOMIC_ACQUIRE, "agent");
            xb_add(&bar[XB_XGEN(b.x)], 1u);
            asm volatile("s_waitcnt vmcnt(0)" ::: "memory");
        } else {
            XB_SPIN(xb_ld(&bar[XB_XGEN(b.x)]) == gen, bar);
            __builtin_amdgcn_fence(__ATOMIC_ACQUIRE, "agent");
            asm volatile("s_waitcnt vmcnt(0)" ::: "memory");
        }
    }
    __syncthreads();
}

struct Args {
    const float* x; const int* pos; const float* gains; const float* w_up; const float* w_dn;
    const float* a_in; const float* a_out; const float* a_sinks; const float* b_in; const float* b_out;
    float* out; unsigned char* ws;
    float inv8[8];
    int ph_lo, ph_hi;
};

struct Frame {
    LAS unsigned char* lds;
    int tid, lane, wave, vcu, G;
};

__device__ __forceinline__ void p0_transpose_item(const float* W, int K, int N, int Npad, f16* WT, LAS float* scr, int item, int lane) {
    const int nblk = Npad / 32, kb = item / nblk, nb = item % nblk, k0 = 64 * kb, n0 = 32 * nb;
    const int nn = n0 + (lane & 31);
#pragma unroll 8
    for (int i = 0; i < 32; ++i) { const int kk = 2 * i + (lane >> 5); scr[kk * 33 + (lane & 31)] = (nn < N) ? W[(size_t)(k0 + kk) * N + nn] : 0.f; }
    asm volatile("s_waitcnt lgkmcnt(0)" ::: "memory");
    const int c = lane & 7;
#pragma unroll
    for (int j = 0; j < 4; ++j) { const int n = (lane >> 3) + 8 * j; const LAS float* s = scr + (8 * c) * 33 + n;
        u32x4 o; o.x = pk2h(s[0 * 33], s[1 * 33]); o.y = pk2h(s[2 * 33], s[3 * 33]); o.z = pk2h(s[4 * 33], s[5 * 33]); o.w = pk2h(s[6 * 33], s[7 * 33]);
        *(u32x4*)(WT + (size_t)(n0 + n) * K + k0 + 8 * c) = o; }
    asm volatile("s_waitcnt lgkmcnt(0)" ::: "memory");
}
__device__ __forceinline__ void rms_row_to_f16(const float* xrow, const float* g, f16* orow, int lane) {
    const f32x4* xr = (const f32x4*)xrow + lane;
    f32x4 v[4]; float s = 0.f;
#pragma unroll
    for (int j = 0; j < 4; ++j) { v[j] = xr[64 * j]; s += (v[j][0] * v[j][0] + v[j][1] * v[j][1]) + (v[j][2] * v[j][2] + v[j][3] * v[j][3]); }
    const float rs = 1.0f / sqrtf(wave_sum(s) * (1.f / D_) + EPS);
#pragma unroll
    for (int j = 0; j < 4; ++j) { const f32x4 gg = ((const f32x4*)g)[lane + 64 * j];
        u32x2 o; o.x = pk2h(v[j][0] * rs * gg[0], v[j][1] * rs * gg[1]); o.y = pk2h(v[j][2] * rs * gg[2], v[j][3] * rs * gg[3]);
        *(u32x2*)(orow + 4 * (lane + 64 * j)) = o; }
}
__device__ __forceinline__ void p0_prologue(const Frame& F, const Args& a) {
    LAS float* scr = (LAS float*)(F.lds + F.wave * 16384);
    const int gw = F.vcu * NWAVES + F.wave, NGW = F.G * NWAVES;
    unsigned char* ws = a.ws;
    constexpr int I_AIN = (D_ / 64) * (A_IN / 32), I_AOUT = (D_ / 64) * (D_ / 32), I_BIN = (D_ / 64) * (B_INP / 32), I_UP = (D_ / 64) * (FF_ / 32), I_DN = (FF_ / 64) * (D_ / 32);
    constexpr int NITEMS = I_AIN + 2 * I_AOUT + I_BIN + 2 * I_UP + 2 * I_DN;
    for (int it = gw; it < NITEMS; it += NGW) {
        int r = it;
        if (r < I_AIN) { p0_transpose_item(a.a_in, D_, A_IN, A_IN, (f16*)(ws + WS_WAIN), scr, r, F.lane); continue; } r -= I_AIN;
        if (r < I_AOUT) { p0_transpose_item(a.a_out, D_, D_, D_, (f16*)(ws + WS_WAOUT), scr, r, F.lane); continue; } r -= I_AOUT;
        if (r < I_BIN) { p0_transpose_item(a.b_in, D_, B_IN, B_INP, (f16*)(ws + WS_WBIN), scr, r, F.lane); continue; } r -= I_BIN;
        if (r < I_AOUT) { p0_transpose_item(a.b_out, D_, D_, D_, (f16*)(ws + WS_WBOUT), scr, r, F.lane); continue; } r -= I_AOUT;
        if (r < I_UP) { p0_transpose_item(a.w_up, D_, FF_, FF_, (f16*)(ws + WS_WUP0), scr, r, F.lane); continue; } r -= I_UP;
        if (r < I_UP) { p0_transpose_item(a.w_up + (size_t)D_ * FF_, D_, FF_, FF_, (f16*)(ws + WS_WUP1), scr, r, F.lane); continue; } r -= I_UP;
        if (r < I_DN) { p0_transpose_item(a.w_dn, FF_, D_, D_, (f16*)(ws + WS_WDN0), scr, r, F.lane); continue; } r -= I_DN;
        p0_transpose_item(a.w_dn + (size_t)FF_ * D_, FF_, D_, D_, (f16*)(ws + WS_WDN1), scr, r, F.lane);
    }
    float* cs = (float*)(ws + WS_CS);
    for (int i = (F.vcu * NTHREADS + F.tid); i < M_ * 8; i += F.G * NTHREADS) {
        const int row = i >> 3, f = i & 7;
        const float ang = (float)a.pos[row] * a.inv8[f];
        cs[row * 16 + f] = cosf(ang); cs[row * 16 + 8 + f] = sinf(ang);
    }
    f16* hn = (f16*)(ws + WS_Y);
    for (int m = gw; m < M_; m += NGW) rms_row_to_f16(a.x + (size_t)m * D_, a.gains, hn + (size_t)m * HN_LD, F.lane);
}

__device__ __forceinline__ void norm_phase(const Frame& F, const float* y, const float* xin, float* xout, const float* g1, const float* g2, f16* hn) {
    const int gw = F.vcu * NWAVES + F.wave, NGW = F.G * NWAVES, lane = F.lane;
    for (int m = gw; m < M_; m += NGW) {
        const f32x4* yr = (const f32x4*)(y + (size_t)m * D_) + lane;
        const f32x4* xr = (const f32x4*)(xin + (size_t)m * D_) + lane;
        f32x4 v[4], r[4]; float s = 0.f;
#pragma unroll
        for (int j = 0; j < 4; ++j) { v[j] = yr[64 * j]; r[j] = xr[64 * j]; s += (v[j][0] * v[j][0] + v[j][1] * v[j][1]) + (v[j][2] * v[j][2] + v[j][3] * v[j][3]); }
        const float rs = 1.0f / sqrtf(wave_sum(s) * (1.f / D_) + EPS);
        float s2 = 0.f;
#pragma unroll
        for (int j = 0; j < 4; ++j) { const f32x4 gg = ((const f32x4*)g1)[lane + 64 * j];
            v[j] = r[j] + v[j] * rs * gg; s2 += (v[j][0] * v[j][0] + v[j][1] * v[j][1]) + (v[j][2] * v[j][2] + v[j][3] * v[j][3]);
            ((f32x4*)(xout + (size_t)m * D_))[lane + 64 * j] = v[j]; }
        if (g2) {
            const float rs2 = 1.0f / sqrtf(wave_sum(s2) * (1.f / D_) + EPS);
#pragma unroll
            for (int j = 0; j < 4; ++j) { const f32x4 gg = ((const f32x4*)g2)[lane + 64 * j];
                u32x2 o; o.x = pk2h(v[j][0] * rs2 * gg[0], v[j][1] * rs2 * gg[1]); o.y = pk2h(v[j][2] * rs2 * gg[2], v[j][3] * rs2 * gg[3]);
                *(u32x2*)(hn + (size_t)m * HN_LD + 4 * (lane + 64 * j)) = o; }
        }
    }
}

__device__ __forceinline__ s16x4 vtr(const LAS unsigned char* p) {
    typedef short v4i16_t __attribute__((ext_vector_type(4)));
    return __builtin_bit_cast(s16x4, __builtin_amdgcn_ds_read_tr16_b64_v4i16((LAS v4i16_t*)p));
}
__device__ __forceinline__ void swa_phase(const Frame& F, const f16* Q, const f16* Kb, const f16* Vb, const float* sinks, f16* O) {
    LAS unsigned char* Ks = F.lds; LAS unsigned char* Vs = F.lds + 36864;
    const int lane = F.lane, r32 = lane & 31, hi = lane >> 5, w = F.wave;
    for (int unit = F.vcu; unit < B_ * 64 * 4; unit += F.G) {
        const int kvh = unit & 3, nb = (unit >> 2) & 63, b = unit >> 8;
        __syncthreads();
#pragma unroll
        for (int i = 0; i < 4; ++i) {
            const int p = F.tid + 512 * i, row = p >> 3, c = p & 7;
            int kpos = 128 * (nb - 1) + row; if (kpos < 0) kpos = row;
            const size_t goff = ((size_t)b * S_ + kpos) * KVD + kvh * 64 + c * 8;
            const u32x4 kv = *(const u32x4*)(Kb + goff); const u32x4 vv = *(const u32x4*)(Vb + goff);
            *(LAS u32x4*)(Ks + row * 144 + c * 16) = kv;
            *(LAS u32x4*)(Vs + (c >> 2) * 16384 + row * 64 + (c & 3) * 16) = vv;
        }
        __syncthreads();
        const int g = w >> 1, head = kvh * 4 + g;
        const float sink = sinks[head];
#pragma unroll 1
        for (int ib = 0; ib < 2; ++ib) {
            const int r0 = 64 * (w & 1) + 32 * ib, r = r0 + r32, T0 = r0 >> 5;
            const size_t qrow = (size_t)b * S_ + 128 * nb + r;
            f16x8 qf[4];
#pragma unroll
            for (int ks = 0; ks < 4; ++ks) qf[ks] = *(const f16x8*)(Q + qrow * QD + head * 64 + 16 * ks + 8 * hi);
            f32x16 sc[5];
#pragma unroll
            for (int i = 0; i < 5; ++i) {
                sc[i] = (f32x16){0.f, 0.f, 0.f, 0.f, 0.f, 0.f, 0.f, 0.f, 0.f, 0.f, 0.f, 0.f, 0.f, 0.f, 0.f, 0.f};
#pragma unroll
                for (int ks = 0; ks < 4; ++ks) {
                    const f16x8 kf = *(const LAS f16x8*)(Ks + (32 * (T0 + i) + r32) * 144 + (16 * ks + 8 * hi) * 2);
                    sc[i] = __builtin_amdgcn_mfma_f32_32x32x16_f16(kf, qf[ks], sc[i], 0, 0, 0);
                }
            }
            float m = -INFINITY;
#pragma unroll
            for (int i = 0; i < 5; ++i)
#pragma unroll
                for (int e = 0; e < 16; ++e) {
                    const int c = 32 * (T0 + i) + (e & 3) + 8 * (e >> 2) + 4 * hi;
                    const bool valid = (c > r) && (c <= r + 128) && (nb > 0 || c >= 128);
                    const float s = valid ? sc[i][e] * 0.125f : -INFINITY;
                    sc[i][e] = s; m = fmaxf(m, s);
                }
            m = fmaxf(m, __shfl_xor(m, 32));
            m = fmaxf(m, sink);
            float l = 0.f;
#pragma unroll
            for (int i = 0; i < 5; ++i)
#pragma unroll
                for (int e = 0; e < 16; ++e) { const float p = __expf(sc[i][e] - m); sc[i][e] = p; l += p; }
            l += __shfl_xor(l, 32);
            l += __expf(sink - m);
            const float il = 1.0f / l;
            f32x16 o[2];
            o[0] = (f32x16){0.f, 0.f, 0.f, 0.f, 0.f, 0.f, 0.f, 0.f, 0.f, 0.f, 0.f, 0.f, 0.f, 0.f, 0.f, 0.f}; o[1] = o[0];
            const int li = lane & 15, g16 = (lane >> 4) & 1;
#pragma unroll
            for (int i = 0; i < 5; ++i)
#pragma unroll
                for (int s = 0; s < 2; ++s) {
                    u32x4 pw; pw.x = pk2h(sc[i][8 * s + 0], sc[i][8 * s + 1]); pw.y = pk2h(sc[i][8 * s + 2], sc[i][8 * s + 3]);
                    pw.z = pk2h(sc[i][8 * s + 4], sc[i][8 * s + 5]); pw.w = pk2h(sc[i][8 * s + 6], sc[i][8 * s + 7]);
                    const f16x8 pf = __builtin_bit_cast(f16x8, pw);
                    const int key0 = 32 * (T0 + i) + 16 * s + 4 * hi;
#pragma unroll
                    for (int db = 0; db < 2; ++db) {
                        const LAS unsigned char* vp = Vs + db * 16384 + (key0 + (li >> 2)) * 64 + g16 * 32 + (li & 3) * 8;
                        const s16x4 lo = vtr(vp), hi4 = vtr(vp + 8 * 64);
                        const f16x8 vf = __builtin_bit_cast(f16x8, (u32x4){__builtin_bit_cast(u32x2, lo).x, __builtin_bit_cast(u32x2, lo).y, __builtin_bit_cast(u32x2, hi4).x, __builtin_bit_cast(u32x2, hi4).y});
                        o[db] = __builtin_amdgcn_mfma_f32_32x32x16_f16(vf, pf, o[db], 0, 0, 0);
                    }
                }
            f16* orow = O + qrow * QD + head * 64;
#pragma unroll
            for (int db = 0; db < 2; ++db)
#pragma unroll
                for (int rg = 0; rg < 4; ++rg) {
                    u32x2 wv; wv.x = pk2h(o[db][4 * rg + 0] * il, o[db][4 * rg + 1] * il); wv.y = pk2h(o[db][4 * rg + 2] * il, o[db][4 * rg + 3] * il);
                    *(u32x2*)(orow + 32 * db + 8 * rg + 4 * hi) = wv;
                }
        }
    }
}

__device__ __forceinline__ void index_phase(const Frame& F, const f16* QI, const f16* KI, const float* WIv, unsigned short* sel) {
    LAS unsigned* keys = (LAS unsigned*)F.lds;
    const int lane = F.lane, r32 = lane & 31, hi = lane >> 5, w = F.wave;
    const int nitems = M_ / 4;
    for (int it = F.vcu; it < nitems; it += F.G) {
        const int gi = nitems - 1 - it;
        const int b = gi & 1, t0 = (gi >> 1) * 4;
        const size_t row0 = (size_t)b * S_ + t0;
        const int ntiles = (t0 + 4 + 31) >> 5;
        f16x8 qf[4];
#pragma unroll
        for (int ks = 0; ks < 4; ++ks) qf[ks] = *(const f16x8*)(QI + row0 * 512 + r32 * 64 + 16 * ks + 8 * hi);
        float wv[4][4];
#pragma unroll
        for (int tk = 0; tk < 4; ++tk) { const f32x4 t = *(const f32x4*)(WIv + (row0 + tk) * 8 + 4 * hi);
#pragma unroll
            for (int i = 0; i < 4; ++i) wv[tk][i] = t[i] * WI_SCALE; }
        __syncthreads();
        for (int tile = w; tile < ntiles; tile += NWAVES) {
            const f16* kp = KI + ((size_t)b * S_ + 32 * tile + r32) * 64 + 8 * hi;
            f16x8 kf[4];
#pragma unroll
            for (int ks = 0; ks < 4; ++ks) kf[ks] = *(const f16x8*)(kp + 16 * ks);
            f32x16 acc = (f32x16){0.f, 0.f, 0.f, 0.f, 0.f, 0.f, 0.f, 0.f, 0.f, 0.f, 0.f, 0.f, 0.f, 0.f, 0.f, 0.f};
#pragma unroll
            for (int ks = 0; ks < 4; ++ks) acc = __builtin_amdgcn_mfma_f32_32x32x16_f16(qf[ks], kf[ks], acc, 0, 0, 0);
            float s[4];
#pragma unroll
            for (int tk = 0; tk < 4; ++tk) { float a = 0.f;
#pragma unroll
                for (int i = 0; i < 4; ++i) a = fmaf(fmaxf(acc[4 * tk + i], 0.f), wv[tk][i], a);
                s[tk] = a + __shfl_xor(a, 32); }
            const int key = 32 * tile + r32;
            if (hi == 0) { keys[0 * S_ + key] = fkey(s[0]); keys[1 * S_ + key] = fkey(s[1]); }
            else         { keys[2 * S_ + key] = fkey(s[2]); keys[3 * S_ + key] = fkey(s[3]); }
        }
        __syncthreads();
        if (w < 4) {
            const int t = t0 + w, n = t + 1;
            unsigned short* so = sel + (row0 + w) * NSEL;
            LAS unsigned* kr = keys + w * S_;
            if (n <= NSEL) {
#pragma unroll
                for (int j = 0; j < 4; ++j) { const int i = lane + 64 * j; so[i] = (unsigned short)((i < n) ? i : 0); }
            } else {
                const int np = (n + 255) & ~255;
                for (int i = n + lane; i < np; i += 64) kr[i] = 0u;
                asm volatile("s_waitcnt lgkmcnt(0)" ::: "memory");
                unsigned T = 0;
                for (int bit = 31; bit >= 0; --bit) {
                    const unsigned cand = T | (1u << bit);
                    int c = 0;
                    for (int base = 0; base < np; base += 256) { const u32x4 v = *(const LAS u32x4*)(kr + base + 4 * lane);
                        c += (v.x >= cand) + (v.y >= cand) + (v.z >= cand) + (v.w >= cand); }
#pragma unroll
                    for (int o = 1; o < 64; o <<= 1) c += __shfl_xor(c, o);
                    if (c >= NSEL) T = cand;
                }
                int cg = 0;
                for (int base = 0; base < np; base += 256) { const u32x4 v = *(const LAS u32x4*)(kr + base + 4 * lane);
                    cg += (v.x > T) + (v.y > T) + (v.z > T) + (v.w > T); }
#pragma unroll
                for (int o = 1; o < 64; o <<= 1) cg += __shfl_xor(cg, o);
                const int need_eq = NSEL - cg;
                int cnt_gt = 0, cnt_eq = 0;
                for (int base = 0; base < np; base += 64) {
                    const int i = base + lane; const unsigned kv = kr[i];
                    const bool gt = kv > T, eq = kv == T;
                    const unsigned long long bgt = __ballot(gt), beq = __ballot(eq);
                    const int pg = cnt_gt + __builtin_amdgcn_mbcnt_hi((unsigned)(bgt >> 32), __builtin_amdgcn_mbcnt_lo((unsigned)bgt, 0));
                    const int pe = cnt_eq + __builtin_amdgcn_mbcnt_hi((unsigned)(beq >> 32), __builtin_amdgcn_mbcnt_lo((unsigned)beq, 0));
                    if (gt) so[pg] = (unsigned short)i;
                    if (eq && pe < need_eq) so[cg + pe] = (unsigned short)i;
                    cnt_gt += __builtin_popcountll(bgt); cnt_eq += __builtin_popcountll(beq);
                }
            }
        }
    }
}

__device__ __forceinline__ void sparse_phase(const Frame& F, const f16* Q, const f16* Kb, const f16* Vb, const unsigned short* sel, f16* O) {
    const int lane = F.lane, w = F.wave, g = lane & 15, kq = lane >> 4;
    LAS unsigned char* Vw = F.lds + w * 8192;
    const int xg = blockIdx.x & 7, cu = blockIdx.x >> 3, ncu = F.G >> 3;
    const int b = xg >> 2, kvh = xg & 3;
    for (int t = cu * NWAVES + w; t < S_; t += ncu * NWAVES) {
        const size_t row = (size_t)b * S_ + t;
        const int cnt = (t + 1 < NSEL) ? t + 1 : NSEL;
        const unsigned short* so = sel + row * NSEL;
        f16x8 qf[2];
#pragma unroll
        for (int ks = 0; ks < 2; ++ks) { qf[ks] = (f16x8){0, 0, 0, 0, 0, 0, 0, 0}; if (g < 4) qf[ks] = *(const f16x8*)(Q + row * QD + (kvh * 4 + g) * 64 + 32 * ks + 8 * kq); }
        f32x4 s[16];
#pragma unroll
        for (int i = 0; i < 16; ++i) {
            const int j = 16 * i + g; const int idx = (j < cnt) ? so[j] : 0;
            const f16* kp = Kb + ((size_t)b * S_ + idx) * KVD + kvh * 64 + 8 * kq;
            const f16x8 k0 = *(const f16x8*)kp, k1 = *(const f16x8*)(kp + 32);
            f32x4 a = (f32x4){0.f, 0.f, 0.f, 0.f};
            a = __builtin_amdgcn_mfma_f32_16x16x32_f16(k0, qf[0], a, 0, 0, 0);
            a = __builtin_amdgcn_mfma_f32_16x16x32_f16(k1, qf[1], a, 0, 0, 0);
            s[i] = a;
        }
        float m = -INFINITY;
#pragma unroll
        for (int i = 0; i < 16; ++i)
#pragma unroll
            for (int e = 0; e < 4; ++e) { const int j = 16 * i + 4 * kq + e; const float v = (j < cnt) ? s[i][e] * 0.125f : -INFINITY; s[i][e] = v; m = fmaxf(m, v); }
        m = fmaxf(m, __shfl_xor(m, 16)); m = fmaxf(m, __shfl_xor(m, 32));
        float l = 0.f;
#pragma unroll
        for (int i = 0; i < 16; ++i)
#pragma unroll
            for (int e = 0; e < 4; ++e) { const float p = __expf(s[i][e] - m); s[i][e] = p; l += p; }
        l += __shfl_xor(l, 16); l += __shfl_xor(l, 32);
        const float il = 1.0f / l;
        f32x4 o[4];
#pragma unroll
        for (int db = 0; db < 4; ++db) o[db] = (f32x4){0.f, 0.f, 0.f, 0.f};
#pragma unroll 1
        for (int c = 0; c < 4; ++c) {
            u32x4 vr[8];
#pragma unroll
            for (int r = 0; r < 8; ++r) { const int j = 64 * c + 8 * r + (lane >> 3); const int idx = (j < cnt) ? so[j] : 0;
                vr[r] = *(const u32x4*)(Vb + ((size_t)b * S_ + idx) * KVD + kvh * 64 + (lane & 7) * 8); }
#pragma unroll
            for (int r = 0; r < 8; ++r) { const int kl = 8 * r + (lane >> 3), pc = lane & 7;
                *(LAS u32x4*)(Vw + (pc >> 1) * 2048 + kl * 32 + (pc & 1) * 16) = vr[r]; }
            asm volatile("s_waitcnt lgkmcnt(0)" ::: "memory");
#pragma unroll
            for (int k2 = 0; k2 < 2; ++k2) {
                const int kk = 2 * c + k2;
                f32x4 pa, pb;
                switch (kk) {
                    case 0: pa = s[0]; pb = s[1]; break; case 1: pa = s[2]; pb = s[3]; break; case 2: pa = s[4]; pb = s[5]; break; case 3: pa = s[6]; pb = s[7]; break;
                    case 4: pa = s[8]; pb = s[9]; break; case 5: pa = s[10]; pb = s[11]; break; case 6: pa = s[12]; pb = s[13]; break; default: pa = s[14]; pb = s[15]; break;
                }
                u32x4 pw; pw.x = pk2h(pa[0], pa[1]); pw.y = pk2h(pa[2], pa[3]); pw.z = pk2h(pb[0], pb[1]); pw.w = pk2h(pb[2], pb[3]);
                const f16x8 pf = __builtin_bit_cast(f16x8, pw);
                const int kl0 = 32 * k2 + 4 * kq;
#pragma unroll
                for (int db = 0; db < 4; ++db) {
                    const LAS unsigned char* vp = Vw + db * 2048 + (kl0 + (g >> 2)) * 32 + (g & 3) * 8;
                    const s16x4 lo = vtr(vp), hi4 = vtr(vp + 16 * 32);
                    const f16x8 vf = __builtin_bit_cast(f16x8, (u32x4){__builtin_bit_cast(u32x2, lo).x, __builtin_bit_cast(u32x2, lo).y, __builtin_bit_cast(u32x2, hi4).x, __builtin_bit_cast(u32x2, hi4).y});
                    o[db] = __builtin_amdgcn_mfma_f32_16x16x32_f16(pf, vf, o[db], 0, 0, 0);
                }
            }
            asm volatile("s_waitcnt lgkmcnt(0)" ::: "memory");
        }
        float ilv[4];
#pragma unroll
        for (int e = 0; e < 4; ++e) ilv[e] = __shfl(il, e);
        if (kq == 0) {
#pragma unroll
            for (int db = 0; db < 4; ++db)
#pragma unroll
                for (int e = 0; e < 4; ++e) O[row * QD + (kvh * 4 + e) * 64 + 16 * db + g] = (f16)(o[db][e] * ilv[e]);
        }
    }
}

constexpr int NPHASE = 16;
__global__ void __launch_bounds__(NTHREADS, 2) fwd_kernel(Args args) {
    extern __shared__ __attribute__((aligned(16))) unsigned char lds_raw[];
    Frame F;
    F.lds = (LAS unsigned char*)lds_raw;
    F.tid = threadIdx.x; F.lane = F.tid & 63; F.wave = __builtin_amdgcn_readfirstlane(F.tid >> 6);
    F.G = gridDim.x; { const int bx = blockIdx.x; F.vcu = (F.G % 8 == 0) ? (bx % 8) * (F.G / 8) + bx / 8 : bx; }
    unsigned char* ws = args.ws;
    volatile LAS unsigned* MISC = (volatile LAS unsigned*)(F.lds + MISC_OFF);
    for (int u = F.tid; u < (LDS_BYTES - LDSCTL_OFF) / 4; u += NTHREADS) ((LAS unsigned*)(F.lds + LDSCTL_OFF))[u] = 0u;
    __syncthreads();
    const int lo = args.ph_lo, hi = args.ph_hi;
    XcdBarrier bar; bar.bar = (unsigned*)(ws + WS_CTL) + CW_BAR; bar.x = 0; bar.st = nullptr;
    if (hi - lo > 1) bar = xcd_barrier_post((unsigned*)(ws + WS_CTL) + CW_BAR, MISC + 8);
#define IN(k) (lo <= (k) && (k) < hi)
#define SEAM(k) do { if (IN(k) && IN((k) + 1)) xcd_barrier(bar); } while (0)
    f16* hn = (f16*)(ws + WS_Y); float* y = (float*)(ws + WS_Y);
    f16 *q = (f16*)(ws + WS_Q), *kb = (f16*)(ws + WS_K), *vb = (f16*)(ws + WS_V), *qi = (f16*)(ws + WS_QI), *ki = (f16*)(ws + WS_KI), *o = (f16*)(ws + WS_O), *h = (f16*)(ws + WS_BIG);
    float* wi = (float*)(ws + WS_WI); const float* cs = (const float*)(ws + WS_CS);
    unsigned short* sel = (unsigned short*)(ws + WS_SEL);
    const float* g0 = args.gains; const float* g1 = args.gains + 4 * D_;

    if (IN(0)) { p0_prologue(F, args); } SEAM(0);
    if (IN(1)) { pg8::Gemm g{hn, (const f16*)(ws + WS_WAIN), M_, A_IN, D_, HN_LD}; pg8::StaticOrder S; S.init(M_, A_IN, F.G, (int)blockIdx.x);
        pg8::EpiProj E{q, kb, vb, qi, ki, wi, cs}; pg8::gemm_phase(F.lds, g, S, E); } SEAM(1);
    if (IN(2)) { swa_phase(F, q, kb, vb, args.a_sinks, o); } SEAM(2);
    if (IN(3)) { pg8::Gemm g{o, (const f16*)(ws + WS_WAOUT), M_, D_, D_, D_}; pg8::StaticOrder S; S.init(M_, D_, F.G, (int)blockIdx.x);
        pg8::EpiY E{y}; pg8::gemm_phase(F.lds, g, S, E); } SEAM(3);
    if (IN(4)) { norm_phase(F, y, args.x, args.out, g0 + D_, g0 + 2 * D_, hn); } SEAM(4);
    if (IN(5)) { pg8::Gemm g{hn, (const f16*)(ws + WS_WUP0), M_, FF_, D_, HN_LD}; pg8::StaticOrder S; S.init(M_, FF_, F.G, (int)blockIdx.x);
        pg8::EpiH E{h}; pg8::gemm_phase(F.lds, g, S, E); } SEAM(5);
    if (IN(6)) { pg8::Gemm g{h, (const f16*)(ws + WS_WDN0), M_, D_, FF_, FF_}; pg8::StaticOrder S; S.init(M_, D_, F.G, (int)blockIdx.x);
        pg8::EpiY E{y}; pg8::gemm_phase(F.lds, g, S, E); } SEAM(6);
    if (IN(7)) { norm_phase(F, y, args.out, args.out, g0 + 3 * D_, g1, hn); } SEAM(7);
    if (IN(8)) { pg8::Gemm g{hn, (const f16*)(ws + WS_WBIN), M_, B_INP, D_, HN_LD}; pg8::StaticOrder S; S.init(M_, B_INP, F.G, (int)blockIdx.x);
        pg8::EpiProj E{q, kb, vb, qi, ki, wi, cs}; pg8::gemm_phase(F.lds, g, S, E); } SEAM(8);
    if (IN(9)) { index_phase(F, qi, ki, wi, sel); } SEAM(9);
    if (IN(10)) { sparse_phase(F, q, kb, vb, sel, o); } SEAM(10);
    if (IN(11)) { pg8::Gemm g{o, (const f16*)(ws + WS_WBOUT), M_, D_, D_, D_}; pg8::StaticOrder S; S.init(M_, D_, F.G, (int)blockIdx.x);
        pg8::EpiY E{y}; pg8::gemm_phase(F.lds, g, S, E); } SEAM(11);
    if (IN(12)) { norm_phase(F, y, args.out, args.out, g1 + D_, g1 + 2 * D_, hn); } SEAM(12);
    if (IN(13)) { pg8::Gemm g{hn, (const f16*)(ws + WS_WUP1), M_, FF_, D_, HN_LD}; pg8::StaticOrder S; S.init(M_, FF_, F.G, (int)blockIdx.x);
        pg8::EpiH E{h}; pg8::gemm_phase(F.lds, g, S, E); } SEAM(13);
    if (IN(14)) { pg8::Gemm g{h, (const f16*)(ws + WS_WDN1), M_, D_, FF_, FF_}; pg8::StaticOrder S; S.init(M_, D_, F.G, (int)blockIdx.x);
        pg8::EpiY E{y}; pg8::gemm_phase(F.lds, g, S, E); } SEAM(14);
    if (IN(15)) { norm_phase(F, y, args.out, args.out, g1 + 3 * D_, nullptr, hn); }
#undef IN
#undef SEAM
}

#ifndef OPTMASK
#define OPTMASK 0xFFFFu
#endif
#ifndef ONE_LAUNCH
#define ONE_LAUNCH 1
#endif

__global__ void k_inv(float* inv8, Args a) { if (threadIdx.x < 8) inv8[threadIdx.x] = a.inv8[threadIdx.x]; }

extern "C" void kernel_launch(void* const* d_in, const int* in_sizes, int n_in, void* d_out, int out_size, void* d_ws, size_t ws_size, hipStream_t stream) {
    static int inited = 0;
    if (!inited) {
        if (ws_size < WS_END) { fprintf(stderr, "kernel_launch: workspace too small: %zu < %zu\n", ws_size, (size_t)WS_END); inited = -1; return; }
        if (hipFuncSetAttribute((const void*)fwd_kernel, hipFuncAttributeMaxDynamicSharedMemorySize, LDS_BYTES) != hipSuccess) { fprintf(stderr, "kernel_launch: hipFuncSetAttribute failed\n"); inited = -1; return; }
        inited = 1;
    }
    if (inited < 0) return;
    Args a{};
    a.x = (const float*)d_in[0]; a.pos = (const int*)d_in[1]; a.gains = (const float*)d_in[2]; a.w_up = (const float*)d_in[3]; a.w_dn = (const float*)d_in[4];
    a.a_in = (const float*)d_in[5]; a.a_out = (const float*)d_in[6]; a.a_sinks = (const float*)d_in[7]; a.b_in = (const float*)d_in[8]; a.b_out = (const float*)d_in[9];
    a.out = (float*)d_out; a.ws = (unsigned char*)d_ws;
    for (int i = 0; i < 8; ++i) a.inv8[i] = (float)pow(500000.0, -(double)i / 8.0);
    unsigned char* ws = (unsigned char*)d_ws;
    (void)hipMemsetAsync(ws + WS_CTL, 0, CTL_ZERO_BYTES, stream);
    const int grid = 256;
#if ONE_LAUNCH
    a.ph_lo = 0; a.ph_hi = NPHASE;
    hipLaunchKernelGGL(fwd_kernel, dim3(grid), dim3(NTHREADS), LDS_BYTES, stream, a);
#else
    f16* hn = (f16*)(ws + WS_Y); float* y = (float*)(ws + WS_Y);
    f16 *q = (f16*)(ws + WS_Q), *kb = (f16*)(ws + WS_K), *vb = (f16*)(ws + WS_V), *qi = (f16*)(ws + WS_QI), *ki = (f16*)(ws + WS_KI), *o = (f16*)(ws + WS_O), *h = (f16*)(ws + WS_BIG);
    float* wi = (float*)(ws + WS_WI); unsigned short* sel = (unsigned short*)(ws + WS_SEL);
    float* inv8 = (float*)(ws + WS_CTL + 32 * 1024);
    const float* g0 = a.gains; const float* g1 = a.gains + 4 * D_;
    float* out = a.out;
    k_inv<<<1, 64, 0, stream>>>(inv8, a);
    auto opt = [&](int p) { Args b = a; b.ph_lo = p; b.ph_hi = p + 1; hipLaunchKernelGGL(fwd_kernel, dim3(grid), dim3(NTHREADS), LDS_BYTES, stream, b); };
    for (int p = 0; p < NPHASE; ++p) {
        const bool useopt = (OPTMASK >> p) & 1u;
        if (p == 0) { if (OPTMASK) opt(0); if (!useopt) nv::k_rms16<<<M_ / 4, 256, 0, stream>>>(a.x, g0, hn); continue; }
        if (useopt) { opt(p); continue; }
        switch (p) {
            case 1: { nv::EpProj ep{q, kb, vb, qi, ki, wi}; nv::k_gemm<<<dim3(A_IN / 64, M_ / 64), 256, 0, stream>>>(hn, HN_LD, a.a_in, A_IN, D_, ep);
                nv::k_rope16<<<(M_ * 16 * 8 + 255) / 256, 256, 0, stream>>>(q, QD, 16, a.pos, inv8); nv::k_rope16<<<(M_ * 4 * 8 + 255) / 256, 256, 0, stream>>>(kb, KVD, 4, a.pos, inv8); } break;
            case 2: nv::k_swa<<<M_ * 16 / 64, 64, 0, stream>>>(q, kb, vb, a.a_sinks, o); break;
            case 3: { nv::EpY ep{y}; nv::k_gemm<<<dim3(D_ / 64, M_ / 64), 256, 0, stream>>>(o, D_, a.a_out, D_, D_, ep); } break;
            case 4: nv::k_normres<<<M_ / 4, 256, 0, stream>>>(y, a.x, out, g0 + D_, g0 + 2 * D_, hn); break;
            case 5: { nv::EpH ep{h}; nv::k_gemm<<<dim3(FF_ / 64, M_ / 64), 256, 0, stream>>>(hn, HN_LD, a.w_up, FF_, D_, ep); } break;
            case 6: { nv::EpY ep{y}; nv::k_gemm<<<dim3(D_ / 64, M_ / 64), 256, 0, stream>>>(h, FF_, a.w_dn, D_, FF_, ep); } break;
            case 7: nv::k_normres<<<M_ / 4, 256, 0, stream>>>(y, out, out, g0 + 3 * D_, g1, hn); break;
            case 8: { nv::EpProj ep{q, kb, vb, qi, ki, wi}; nv::k_gemm<<<dim3((B_IN + 63) / 64, M_ / 64), 256, 0, stream>>>(hn, HN_LD, a.b_in, B_IN, D_, ep);
                nv::k_rope16<<<(M_ * 16 * 8 + 255) / 256, 256, 0, stream>>>(q, QD, 16, a.pos, inv8); nv::k_rope16<<<(M_ * 4 * 8 + 255) / 256, 256, 0, stream>>>(kb, KVD, 4, a.pos, inv8);
                nv::k_rope16<<<(M_ * 8 * 8 + 255) / 256, 256, 0, stream>>>(qi, 512, 8, a.pos, inv8); nv::k_rope16<<<(M_ * 1 * 8 + 255) / 256, 256, 0, stream>>>(ki, 64, 1, a.pos, inv8); } break;
            case 9: nv::k_index<<<M_, 256, 0, stream>>>(qi, ki, wi, sel); break;
            case 10: nv::k_sparse<<<M_ * 16 / 64, 64, 0, stream>>>(q, kb, vb, sel, o); break;
            case 11: { nv::EpY ep{y}; nv::k_gemm<<<dim3(D_ / 64, M_ / 64), 256, 0, stream>>>(o, D_, a.b_out, D_, D_, ep); } break;
            case 12: nv::k_normres<<<M_ / 4, 256, 0, stream>>>(y, out, out, g1 + D_, g1 + 2 * D_, hn); break;
            case 13: { nv::EpH ep{h}; nv::k_gemm<<<dim3(FF_ / 64, M_ / 64), 256, 0, stream>>>(hn, HN_LD, a.w_up + (size_t)D_ * FF_, FF_, D_, ep); } break;
            case 14: { nv::EpY ep{y}; nv::k_gemm<<<dim3(D_ / 64, M_ / 64), 256, 0, stream>>>(h, FF_, a.w_dn + (size_t)FF_ * D_, D_, FF_, ep); } break;
            case 15: nv::k_normres<<<M_ / 4, 256, 0, stream>>>(y, out, out, g1 + 3 * D_, nullptr, hn); break;
        }
    }
#endif
}
```
